# Optimizing an MI355X kernel written in HIP

```python
import jax, jax.numpy as jnp
from jax import lax
import numpy as np

D_MODEL = 1024
BATCH = 8
SEQ = 2048
DEPTH = 2
DEC_BATCH = 16
DEC_SEQ = 2048
PAST_LEN = 128

PLE_DIM = 256
GRID_W = 64
N_BRANCH = 4
BRANCH_W = D_MODEL // 2
RET_HEADS = 4
RET_QK = BRANCH_W // (2 * RET_HEADS)
RET_V = BRANCH_W // RET_HEADS
RET_CHUNK = 128
ROPE_BASE = 10000.0
NAT_HEADS = 8
NAT_HD = BRANCH_W // NAT_HEADS
NAT_WIN_ROWS = 8
NAT_WIN_COLS = 16
LRU_BLOCKS = 8
LRU_BW = BRANCH_W // LRU_BLOCKS
LRU_CONV = 4
LRU_C = 8.0
HGRN_HEADS = 4
HGRN_DK = BRANCH_W // HGRN_HEADS
HGRN_DV = BRANCH_W // HGRN_HEADS
HGRN_CHUNK = 32
EPS = 1e-6

IN_SPLIT_SIZES = (
    RET_HEADS * RET_QK, RET_HEADS * RET_QK, RET_HEADS * RET_V, BRANCH_W,
    BRANCH_W, BRANCH_W, BRANCH_W, BRANCH_W,
    BRANCH_W, BRANCH_W,
    HGRN_HEADS * HGRN_DK, HGRN_HEADS * HGRN_DK, HGRN_HEADS * HGRN_DK,
    HGRN_HEADS * HGRN_DV, BRANCH_W,
)
W_IN = sum(IN_SPLIT_SIZES)
IN_SPLIT_POINTS = tuple(int(c) for c in np.cumsum(IN_SPLIT_SIZES)[:-1])

kernel_name = 'hybrid_bidir_gated_encoder'

F32 = jnp.float32


def rms_norm(x, g):
    xf = x.astype(F32)
    y = xf * lax.rsqrt(jnp.mean(xf * xf, axis=-1, keepdims=True) + EPS)
    return (y * g.astype(F32)).astype(x.dtype)


def head_rms(o):
    return o * lax.rsqrt(jnp.mean(o * o, axis=-1, keepdims=True) + EPS)


def rev_t(a):
    return jnp.flip(a, axis=1)


def rotary(x, pos):
    half = x.shape[-1] // 2
    inv = ROPE_BASE ** (-jnp.arange(half, dtype=F32) / half)
    ang = pos[:, None] * inv[None, :]
    cos = jnp.cos(ang)[:, None, :]
    sin = jnp.sin(ang)[:, None, :]
    x1, x2 = x[..., :half], x[..., half:]
    return jnp.concatenate([x1 * cos - x2 * sin, x1 * sin + x2 * cos], axis=-1)


def retention_scan(q, k, v, log_gamma):
    B, T, H, dk = q.shape
    dv = v.shape[-1]
    C = RET_CHUNK
    N = T // C
    qc = q.reshape(B, N, C, H, dk)
    kc = k.reshape(B, N, C, H, dk)
    vc = v.reshape(B, N, C, H, dv)
    tt = jnp.arange(C, dtype=F32)
    diff = tt[:, None] - tt[None, :]
    intra = jnp.where(diff >= 0, jnp.exp(jnp.maximum(diff, 0.0)[None] * log_gamma[:, None, None]), 0.0)
    scores = jnp.einsum('bnthd,bnshd->bnhts', qc, kc) * intra
    o = jnp.einsum('bnhts,bnshv->bnthv', scores, vc)
    k_tail = jnp.exp((C - 1 - tt)[:, None] * log_gamma[None, :])
    local = jnp.einsum('bnshd,sh,bnshv->bnhdv', kc, k_tail, vc)
    chunk_decay = jnp.exp(C * log_gamma)[:, None, None]

    def step(state, loc):
        return chunk_decay * state + loc, state

    _, prev = lax.scan(step, jnp.zeros((B, H, dk, dv), F32), jnp.moveaxis(local, 1, 0))
    prev = jnp.moveaxis(prev, 0, 1)
    q_head = jnp.exp((tt + 1.0)[:, None] * log_gamma[None, :])
    o = o + jnp.einsum('bnthd,th,bnhdv->bnthv', qc, q_head, prev)
    return o.reshape(B, T, H, dv)


def retention_branch(q, k, v, decay_logit):
    B, T, _ = q.shape
    pos = jnp.arange(T, dtype=F32)
    qh = rotary(q.astype(F32).reshape(B, T, RET_HEADS, RET_QK), pos)
    kh = rotary(k.astype(F32).reshape(B, T, RET_HEADS, RET_QK), pos) * (RET_QK ** -0.5)
    vh = v.astype(F32).reshape(B, T, RET_HEADS, RET_V)
    log_gamma = jax.nn.log_sigmoid(decay_logit.astype(F32))
    o = retention_scan(qh, kh, vh, log_gamma[0]) + rev_t(
        retention_scan(rev_t(qh), rev_t(kh), rev_t(vh), log_gamma[1]))
    return head_rms(o).reshape(B, T, BRANCH_W).astype(q.dtype)


def neighbourhood_attention_branch(q, k, v, rpb):
    B, T, _ = q.shape
    rows = T // GRID_W
    wr = min(NAT_WIN_ROWS, rows)
    n_cb = GRID_W // NAT_WIN_COLS
    kw = 2 * NAT_WIN_COLS
    grid = (B, rows, GRID_W, NAT_HEADS, NAT_HD)
    qg = (q * (NAT_HD ** -0.5)).reshape(B, rows, n_cb, NAT_WIN_COLS, NAT_HEADS, NAT_HD)
    kg = k.reshape(grid)
    vg = v.reshape(grid)
    qcols = jnp.arange(GRID_W).reshape(n_cb, NAT_WIN_COLS)
    kstart = jnp.clip(jnp.arange(n_cb) * NAT_WIN_COLS - NAT_WIN_COLS // 2, 0, GRID_W - kw)
    kcols = kstart[:, None] + jnp.arange(kw)
    wstart = jnp.clip(qcols - NAT_WIN_COLS // 2, 0, GRID_W - NAT_WIN_COLS)
    col_ok = (kcols[:, None, :] >= wstart[..., None]) & (kcols[:, None, :] < wstart[..., None] + NAT_WIN_COLS)
    dc_idx = jnp.clip(kcols[:, None, :] - qcols[..., None] + NAT_WIN_COLS - 1, 0, 2 * NAT_WIN_COLS - 2)
    rpb = rpb.astype(F32)

    def row_block(r):
        rs = jnp.clip(r - wr // 2, 0, rows - wr)
        kb = lax.dynamic_slice_in_dim(kg, rs, wr, axis=1)[:, :, kcols]
        vb = lax.dynamic_slice_in_dim(vg, rs, wr, axis=1)[:, :, kcols]
        qr = qg[:, r]
        s = jnp.einsum('bjqhd,bwjkhd->bhjqwk', qr, kb).astype(F32)
        dr_idx = rs + jnp.arange(wr) - r + NAT_WIN_ROWS - 1
        bias = rpb[:, dr_idx[:, None, None, None], dc_idx[None]]
        bias = bias.transpose(0, 2, 3, 1, 4)
        s = jnp.where(col_ok[:, :, None, :], s + bias, -jnp.inf)
        p = jax.nn.softmax(s, axis=(-2, -1)).astype(vb.dtype)
        return jnp.einsum('bhjqwk,bwjkhd->bjqhd', p, vb)

    o = lax.map(row_block, jnp.arange(rows))
    return jnp.moveaxis(o, 0, 1).reshape(B, T, BRANCH_W).astype(q.dtype)


def rg_lru(xc, wa, ba, wx, bx, lam, reverse):
    B, T, W = xc.shape
    xb = xc.reshape(B, T, LRU_BLOCKS, LRU_BW)
    r = jax.nn.sigmoid(jnp.einsum('btnj,njk->btnk', xb, wa.astype(F32)).reshape(B, T, W) + ba.astype(F32))
    i = jax.nn.sigmoid(jnp.einsum('btnj,njk->btnk', xb, wx.astype(F32)).reshape(B, T, W) + bx.astype(F32))
    log_a = -LRU_C * r * jax.nn.softplus(-lam.astype(F32))
    a = jnp.exp(log_a)
    b = jnp.sqrt(-jnp.expm1(2.0 * log_a)) * (i * xc)

    def combine(e1, e2):
        a1, b1 = e1
        a2, b2 = e2
        return a1 * a2, a2 * b1 + b2

    _, h = lax.associative_scan(combine, (a, b), axis=1, reverse=reverse)
    return h


def rglru_branch(xin, conv_w, conv_b, wa, ba, wx, bx, lam):
    C = xin.shape[-1]
    xc = lax.conv_general_dilated(
        xin.astype(F32), conv_w.astype(F32)[:, None, :], window_strides=(1,),
        padding=[(LRU_CONV // 2, LRU_CONV - 1 - LRU_CONV // 2)],
        dimension_numbers=('NWC', 'WIO', 'NWC'), feature_group_count=C) + conv_b.astype(F32)
    h = rg_lru(xc, wa[0], ba[0], wx[0], bx[0], lam[0], False) + rg_lru(xc, wa[1], ba[1], wx[1], bx[1], lam[1], True)
    return h.astype(xin.dtype)


def gla_chunk(q, k, v, log_f):
    B, T, H, dk = q.shape
    dv = v.shape[-1]
    C = HGRN_CHUNK
    N = T // C

    def chunks(a):
        return jnp.moveaxis(a.reshape(B, N, C, H, a.shape[-1]), 1, 0)

    causal = jnp.tril(jnp.ones((C, C), bool))[None, :, :, None, None]

    def step(S, inp):
        qn, kn, vn, gn = inp
        b = jnp.cumsum(gn, axis=1)
        o_inter = jnp.einsum('bthk,bhkv->bthv', qn * jnp.exp(b), S)
        diff = b[:, :, None] - b[:, None, :]
        dec = jnp.exp(jnp.where(causal, diff, -jnp.inf))
        att = jnp.einsum('btshk,bshk->bhts', qn[:, :, None] * dec, kn)
        o_intra = jnp.einsum('bhts,bshv->bthv', att, vn)
        b_last = b[:, -1]
        S = jnp.exp(b_last)[..., None] * S + jnp.einsum('bshk,bshv->bhkv', kn * jnp.exp(b_last[:, None] - b), vn)
        return S, o_inter + o_intra

    _, o = lax.scan(step, jnp.zeros((B, H, dk, dv), F32), (chunks(q), chunks(k), chunks(v), chunks(log_f)))
    return jnp.moveaxis(o, 0, 1).reshape(B, T, H, dv)


def hgrn2_branch(q, f_fwd, f_bwd, i, lb, gain):
    B, T, _ = q.shape
    kshape = (B, T, HGRN_HEADS, HGRN_DK)
    qh = jax.nn.silu(q.astype(F32)).reshape(kshape)
    vh = i.astype(F32).reshape(B, T, HGRN_HEADS, HGRN_DV)

    def gates(zf, lb_d):
        f = lb_d + (1.0 - lb_d) * jax.nn.sigmoid(zf.astype(F32))
        return (1.0 - f).reshape(kshape), jnp.log(f).reshape(kshape)

    k_f, g_f = gates(f_fwd, lb[0])
    k_b, g_b = gates(f_bwd, lb[1])
    o = gla_chunk(qh, k_f, vh, g_f) + rev_t(gla_chunk(rev_t(qh), rev_t(k_b), rev_t(vh), rev_t(g_b)))
    o = head_rms(o) * gain.astype(F32).reshape(HGRN_HEADS, HGRN_DV)
    return o.reshape(B, T, BRANCH_W).astype(q.dtype)


def hgrn_lower_bounds(logits):
    sm = jax.nn.softmax(logits.astype(F32), axis=0)
    return jnp.cumsum(sm, axis=0) - sm[0:1]


def mixer_layer(x, p_l, g_mix, w_in_l, ret_logit, rpb, conv_w, conv_b, wa, ba, wx, bx, lam, lb, hgrn_gain,
                w_br, w_mg, w_o, g_ple, w_pg, w_pp):
    h = rms_norm(x, g_mix)
    z = h @ w_in_l
    (rq, rk, rv, rg, nq, nk, nv, ng, lx, lg, hq, hff, hfb, hi, hg) = jnp.split(z, IN_SPLIT_POINTS, axis=-1)
    branches = (
        retention_branch(rq, rk, rv, ret_logit) * jax.nn.silu(rg),
        neighbourhood_attention_branch(nq, nk, nv, rpb) * jax.nn.silu(ng),
        rglru_branch(lx, conv_w, conv_b, wa, ba, wx, bx, lam) * jax.nn.silu(lg),
        hgrn2_branch(hq, hff, hfb, hi, lb, hgrn_gain) * jax.nn.silu(hg),
    )
    merged = jax.nn.sigmoid(h @ w_mg[0]) * (branches[0] @ w_br[0])
    for j in range(1, N_BRANCH):
        merged = merged + jax.nn.sigmoid(h @ w_mg[j]) * (branches[j] @ w_br[j])
    x = x + merged @ w_o
    gate = jax.nn.sigmoid(rms_norm(x, g_ple) @ w_pg)
    return x + gate * (p_l.astype(x.dtype) @ w_pp)


def encoder(x, p, lb_all, weights):
    (norm_mix, w_in, ret_decay_logit, nat_rpb, lru_conv_w, lru_conv_b, lru_wa, lru_ba, lru_wx, lru_bx,
     lru_lambda, hgrn_norm, w_branch, w_merge, w_out, ple_norm, w_ple_gate, w_ple_proj, final_norm) = weights
    for l in range(DEPTH):
        x = mixer_layer(x, p[l], norm_mix[l], w_in[l], ret_decay_logit[l], nat_rpb[l], lru_conv_w[l], lru_conv_b[l],
                        lru_wa[l], lru_ba[l], lru_wx[l], lru_bx[l], lru_lambda[l], lb_all[l], hgrn_norm[l],
                        w_branch[l], w_merge[l], w_out[l], ple_norm[l], w_ple_gate[l], w_ple_proj[l])
    return rms_norm(x, final_norm)


def setup_inputs(seed: int = 0) -> dict:
    key = jax.random.key(seed)
    ks = jax.random.split(key, 24)

    def nrm(k, shape, scale):
        return jax.random.normal(k, shape, F32) * scale

    ret_base = jnp.asarray(np.log(2.0 ** (5.0 + np.arange(RET_HEADS)) - 1.0), F32)
    a_c = jax.random.uniform(ks[14], (DEPTH, 2, BRANCH_W), F32, 0.9, 0.999)
    a = a_c ** (1.0 / LRU_C)
    return {
        'x_prompt': nrm(ks[0], (BATCH, SEQ, D_MODEL), 1.0),
        'x_sample': nrm(ks[1], (DEC_BATCH, DEC_SEQ, D_MODEL), 1.0),
        'p_prompt': nrm(ks[2], (DEPTH, BATCH, SEQ, PLE_DIM), 1.0),
        'p_sample': nrm(ks[3], (DEPTH, DEC_BATCH, DEC_SEQ, PLE_DIM), 1.0),
        'norm_mix': 1.0 + nrm(ks[4], (DEPTH, D_MODEL), 0.05),
        'w_in': nrm(ks[5], (DEPTH, D_MODEL, W_IN), D_MODEL ** -0.5),
        'ret_decay_logit': ret_base + nrm(ks[6], (DEPTH, 2, RET_HEADS), 0.05),
        'nat_rpb': nrm(ks[7], (DEPTH, NAT_HEADS, 2 * NAT_WIN_ROWS - 1, 2 * NAT_WIN_COLS - 1), 0.02),
        'lru_conv_w': nrm(ks[8], (DEPTH, LRU_CONV, BRANCH_W), LRU_CONV ** -0.5),
        'lru_conv_b': nrm(ks[9], (DEPTH, BRANCH_W), 0.02),
        'lru_wa': nrm(ks[10], (DEPTH, 2, LRU_BLOCKS, LRU_BW, LRU_BW), LRU_BW ** -0.5),
        'lru_ba': nrm(ks[11], (DEPTH, 2, BRANCH_W), 0.02),
        'lru_wx': nrm(ks[12], (DEPTH, 2, LRU_BLOCKS, LRU_BW, LRU_BW), LRU_BW ** -0.5),
        'lru_bx': nrm(ks[13], (DEPTH, 2, BRANCH_W), 0.02),
        'lru_lambda': jnp.log(a) - jnp.log1p(-a),
        'hgrn_lb_logits': nrm(ks[15], (DEPTH, 2, HGRN_HEADS * HGRN_DK), 0.5),
        'hgrn_norm': 1.0 + nrm(ks[16], (DEPTH, HGRN_HEADS * HGRN_DV), 0.05),
        'w_branch': nrm(ks[17], (DEPTH, N_BRANCH, BRANCH_W, D_MODEL), BRANCH_W ** -0.5),
        'w_merge': nrm(ks[18], (DEPTH, N_BRANCH, D_MODEL, D_MODEL), D_MODEL ** -0.5),
        'w_out': nrm(ks[19], (DEPTH, D_MODEL, D_MODEL), D_MODEL ** -0.5),
        'ple_norm': 1.0 + nrm(ks[20], (DEPTH, D_MODEL), 0.05),
        'w_ple_gate': nrm(ks[21], (DEPTH, D_MODEL, D_MODEL), D_MODEL ** -0.5),
        'w_ple_proj': nrm(ks[22], (DEPTH, PLE_DIM, D_MODEL), PLE_DIM ** -0.5),
        'final_norm': 1.0 + nrm(ks[23], (D_MODEL,), 0.05),
    }


def reference(x_prompt, x_sample, p_prompt, p_sample, norm_mix, w_in, ret_decay_logit, nat_rpb, lru_conv_w,
              lru_conv_b, lru_wa, lru_ba, lru_wx, lru_bx, lru_lambda, hgrn_lb_logits, hgrn_norm, w_branch,
              w_merge, w_out, ple_norm, w_ple_gate, w_ple_proj, final_norm):
    lb_all = hgrn_lower_bounds(hgrn_lb_logits)
    weights = (norm_mix, w_in, ret_decay_logit, nat_rpb, lru_conv_w, lru_conv_b, lru_wa, lru_ba, lru_wx, lru_bx,
               lru_lambda, hgrn_norm, w_branch, w_merge, w_out, ple_norm, w_ple_gate, w_ple_proj, final_norm)
    y_prompt = encoder(x_prompt, p_prompt, lb_all, weights)
    y_sample = encoder(x_sample, p_sample, lb_all, weights)
    return (y_prompt, y_sample)
```

```cpp
#include <hip/hip_runtime.h>
#include <hip/hip_cooperative_groups.h>
#include <cstdio>
namespace cg = cooperative_groups;

#define LAS __attribute__((address_space(3)))
typedef unsigned short bf16_t;
typedef short bf16x8 __attribute__((ext_vector_type(8)));
typedef float f32x4 __attribute__((ext_vector_type(4)));
typedef float f32x2 __attribute__((ext_vector_type(2)));
typedef unsigned u32x4 __attribute__((ext_vector_type(4)));
typedef unsigned u32x2 __attribute__((ext_vector_type(2)));

constexpr int T_ = 2048, DM = 1024, GS = 8, MG = GS * T_  , NGRP = 3, WIN = 7168, DEPTH_ = 2, PLE = 256;
constexpr int NPROMPT = 8 * 2048;
constexpr float EPS_ = 1e-6f;
constexpr int C_RQ = 0, C_RK = 256, C_RG = 1024, C_NQ = 1536, C_NK = 2048, C_NG = 3072, C_LX = 3584, C_LG = 4096,
              C_HQ = 4608, C_HFF = 5120, C_HFB = 5632, C_HI = 6144, C_HG = 6656;
constexpr size_t WS_CTL = 0, WS_ROPE = 65536, WS_WT = 1u << 20;
constexpr size_t WT_IN = 0, WT_MG = 7340032, WT_BR = 11534336, WT_O = 13631488, WT_PG = 14680064, WT_PP = 15728640, WT_LAYER = 15990784;
constexpr size_t WS_H = WS_WT + 67108864, WS_P16 = WS_H + 33554432, WS_BR = WS_P16 + 8388608, WS_CS = WS_BR + 67108864,
                 WS_OD = WS_CS + 33554432, WS_VT = WS_OD + 33554432, WS_Z = WS_VT + 33554432, WS_END = WS_Z + 234881024;
constexpr size_t WS_MERGED = WS_Z, WS_SG = WS_Z + 33554432, WS_PART = WS_SG + 134217728;
static_assert(WS_PART + 67108864 <= WS_END, "alias map");
constexpr int LDS_CTL = 131072, LDS_TAB = LDS_CTL + 64, LDS_BYTES = 131072 + 512;
constexpr int NT = 512;
constexpr int CTL_SLOT = 128;
constexpr int NU_D = 256, NU_A = 256, NU_C = 128, NU_B = 1024, NU_ALL = NU_D + NU_A + NU_C + NU_B;

struct Args { const float* in[24]; float* out; unsigned char* ws; };

__device__ __forceinline__ unsigned cvt_pk_bf16(float lo, float hi) { unsigned r; asm volatile("v_cvt_pk_bf16_f32 %0, %1, %2" : "=v"(r) : "v"(lo), "v"(hi)); return r; }
__device__ __forceinline__ bf16_t f2bf(float f) { return (bf16_t)(cvt_pk_bf16(f, 0.f) & 0xffffu); }
__device__ __forceinline__ float bf2f(bf16_t b) { return __uint_as_float(((unsigned)b) << 16); }
__device__ __forceinline__ float bflo(unsigned w) { return __uint_as_float(w << 16); }
__device__ __forceinline__ float bfhi(unsigned w) { return __uint_as_float(w & 0xffff0000u); }
__device__ __forceinline__ float sigm(float x) { return 1.f / (1.f + __expf(-x)); }
__device__ __forceinline__ float siluf(float x) { return x * sigm(x); }

__device__ __forceinline__ int fresh_tid() { int t = threadIdx.x; asm volatile("" : "+v"(t)); return t; }
typedef __attribute__((address_space(1))) unsigned char gbyte_t;
__device__ __forceinline__ unsigned char* ldptr(const unsigned char* lds, int k) {
    const volatile LAS unsigned* tab = (const volatile LAS unsigned*)((LAS unsigned char*)lds + LDS_TAB);
    const unsigned lo = __builtin_amdgcn_readfirstlane(tab[2 * k]), hi = __builtin_amdgcn_readfirstlane(tab[2 * k + 1]);
    gbyte_t* gp = (gbyte_t*)(((unsigned long long)hi << 32) | lo);
    return (unsigned char*)gp;
}
#define AIN(k) ((const float*)ldptr(lds, (k)))
#define AOUT ((float*)ldptr(lds, 24))
#define AWS ((unsigned char*)ldptr(lds, 25))
__device__ __forceinline__ float shx(float v, int o, int lane) { return __int_as_float(__builtin_amdgcn_ds_bpermute((lane ^ o) << 2, __float_as_int(v))); }
__device__ __forceinline__ float wave_sum(float v, int lane) {
#pragma unroll
    for (int o = 1; o < 64; o <<= 1) v += shx(v, o, lane);
    return v;
}
__device__ __forceinline__ float softplus_neg(float x) { const float e = __expf(-x);
    return e < 0.0625f ? e * (1.f - e * (0.5f - e * ((1.f / 3.f) - e * (0.25f - e * (0.2f - e * (1.f / 6.f)))))) : __logf(1.f + e); }
__device__ __forceinline__ float one_minus_exp(float y) { const float t = -y;
    return t < 0.125f ? t * (1.f - t * (0.5f - t * ((1.f / 6.f) - t * ((1.f / 24.f) - t * ((1.f / 120.f) - t * (1.f / 720.f)))))) : 1.f - __expf(y); }
#define LDS_WAIT() asm volatile("s_waitcnt lgkmcnt(0)" ::: "memory")
#define VM_WAIT() asm volatile("s_waitcnt vmcnt(0)" ::: "memory")

namespace pg8 {
constexpr int BM = 256, BK = 64, HALF = 128, HTB = HALF * BK * 2, STAGE_BYTES = 8 * HTB, NXCD = 8, WGM = 8;
__device__ __forceinline__ int lds_byte(int r, int c) { const int st = (r >> 4) * 2 + (c >> 5), rr = r & 15, cc = c & 31, ob = rr * 64 + cc * 2; return st * 1024 + (ob ^ (((ob >> 9) & 1) << 5)); }
__device__ __forceinline__ void stage_rc(int b, int& R, int& C) { const int st = b / 1024, sb = b % 1024, swz = sb ^ (((sb >> 9) & 1) << 5); R = (st >> 1) * 16 + swz / 64; C = (st & 1) * 32 + (swz % 64) / 2; }
__device__ __forceinline__ int perm32(int rho) { const int n = rho >> 4, i = rho & 15; return 8 * (i >> 2) + 4 * n + (i & 3); }
struct Unit { int pm, pn; };
struct Gemm { const bf16_t* A; const bf16_t* Bt; int M, N, K; };
struct StaticOrder {
    int nM, nN, nwg, G, c;
    __device__ __forceinline__ void init(int M, int N, int G_, int c_) { nM = M / BM; nN = N / BM; nwg = nM * nN; G = G_; c = c_; }
    __device__ __forceinline__ bool next(int i, Unit& u) const {
        const long L = (long)i * G + c; if (L >= nwg) return false;
        int wgid = (int)L; { const int q = nwg / NXCD, r = nwg % NXCD, xcd = wgid % NXCD, off = wgid / NXCD; wgid = (xcd < r ? xcd * (q + 1) : r * (q + 1) + (xcd - r) * q) + off; }
        const int nig = WGM * nN, gid = wgid / nig, fm = gid * WGM, gsz = (nM - fm) < WGM ? (nM - fm) : WGM;
        u.pm = fm + ((wgid % nig) % gsz); u.pn = (wgid % nig) / gsz; return true;
    }
};
struct ListOrder {
    int pm, pn, dpm, dpn, n;
    __device__ __forceinline__ bool next(int i, Unit& u) const { if (i >= n) return false; u.pm = pm + i * dpm; u.pn = pn + i * dpn; return true; }
};

struct ZOrder {
    StaticOrder so;
    __device__ __forceinline__ void init(int G_, int c_) { so.init(16384, 24 * 256, G_, c_); }
    __device__ __forceinline__ bool next(int i, Unit& u) const { if (!so.next(i, u)) return false; u.pn = u.pn < 2 ? u.pn : (u.pn < 8 ? u.pn + 2 : u.pn + 4); return true; }
};
struct VTOrder {
    int G, c;
    __device__ __forceinline__ bool next(int i, Unit& u) const { const int L = i * G + c; if (L >= 256) return false; const int w = L & 3; u.pm = (w < 2) ? 2 + w : 8 + w; u.pn = L >> 2; return true; }
};
struct TileOrder {
    int G, c, nj, dpm;
    __device__ __forceinline__ bool next(int i, Unit& u) const { const int j = i % nj; const int t = (i / nj) * G + c; if (t >= 256) return false; u.pm = (t >> 2) + j * dpm; u.pn = (t & 3) + 4 * j; return true; }
};
template <class Epi, class Sched>
__device__ __forceinline__ void gemm_phase(LAS unsigned char* lds, const Gemm g, const Sched& S, const Epi& E) {
    const int tid = fresh_tid(), wid = __builtin_amdgcn_readfirstlane(tid >> 6), lane = tid & 63, wr = wid >> 2, wc = wid & 3, fr = lane & 15, fq = lane >> 4;
    const int K = g.K, nt = K / BK;
    unsigned voffA[2], voffB[2];
#pragma unroll
    for (int i = 0; i < 2; ++i) { int R, C; stage_rc(tid * 16 + i * 8192, R, C); const int Rb = Epi::PERM ? ((R & ~31) + perm32(R & 31)) : R;
        voffA[i] = (unsigned)(R * K + C) * 2u; voffB[i] = (unsigned)(Rb * K + C) * 2u; }
    const size_t kstep = (size_t)(BK * 2);
    const size_t hstep = (size_t)HALF * K * 2;
    const size_t tstep = 2 * hstep;
    const unsigned ldsw = (unsigned)wid * 1024u;
    const int aoff = lds_byte(wr * 64 + fr, fq * 8), boff = lds_byte(wc * 32 + fr, fq * 8);
#define PG8_SA(b, h) (((b) * 2 + (h)) * HTB)
#define PG8_SB(b, h) ((4 + (b) * 2 + (h)) * HTB)
#define PG8_STAGE(bufoff, gbase, voff) do { _Pragma("unroll") for (int _i = 0; _i < 2; ++_i) \
        __builtin_amdgcn_global_load_lds((const unsigned*)((const char*)(gbase) + (voff)[_i]), (LAS unsigned*)(lds + (bufoff) + ldsw + _i * 8192), 16, 0, 0); } while (0)
#define PG8_LDA(dst, b, h) do { _Pragma("unroll") for (int m = 0; m < 4; ++m) _Pragma("unroll") for (int k = 0; k < 2; ++k) dst[m][k] = *(const LAS bf16x8*)(lds + PG8_SA(b, h) + aoff + m * 2048 + k * 1024); } while (0)
#define PG8_LDB(dst, b, h) do { _Pragma("unroll") for (int n = 0; n < 2; ++n) _Pragma("unroll") for (int k = 0; k < 2; ++k) dst[n][k] = *(const LAS bf16x8*)(lds + PG8_SB(b, h) + boff + n * 2048 + k * 1024); } while (0)
#define PG8_MMA(ai, bj, At, Bt) do { __builtin_amdgcn_s_setprio(1); _Pragma("unroll") for (int m = 0; m < 4; ++m) _Pragma("unroll") for (int n = 0; n < 2; ++n) _Pragma("unroll") for (int k = 0; k < 2; ++k) \
        acc[ai][bj][m][n] = __builtin_amdgcn_mfma_f32_16x16x32_bf16(Bt[n][k], At[m][k], acc[ai][bj][m][n], 0, 0, 0); __builtin_amdgcn_s_setprio(0); } while (0)
#define PG8_WAIT_V(n) asm volatile("s_waitcnt vmcnt(" #n ")" ::: "memory")
#define PG8_WAIT_L(n) asm volatile("s_waitcnt lgkmcnt(" #n ")" ::: "memory")
#define PG8_BAR __builtin_amdgcn_s_barrier()
#define PG8_SCHED __builtin_amdgcn_sched_barrier(0)
    Unit cur, nxt; int ui = 0;
    if (!S.next(0, cur)) return;
    f32x4 acc[2][2][4][2];
#pragma unroll
    for (int a = 0; a < 2; ++a)
#pragma unroll
        for (int b = 0; b < 2; ++b)
#pragma unroll
            for (int m = 0; m < 4; ++m)
#pragma unroll
                for (int n = 0; n < 2; ++n) acc[a][b][m][n] = (f32x4){0.f, 0.f, 0.f, 0.f};
    bf16x8 At[4][2], B0[2][2], B1[2][2];
    const char* cA = (const char*)g.A + (size_t)cur.pm * tstep; const char* cB = (const char*)g.Bt + (size_t)cur.pn * tstep;
    PG8_STAGE(PG8_SB(0, 0), cB, voffB); PG8_STAGE(PG8_SA(0, 0), cA, voffA); PG8_STAGE(PG8_SB(0, 1), cB + hstep, voffB); PG8_STAGE(PG8_SA(0, 1), cA + hstep, voffA);
    if (wr == 1) PG8_BAR;
    PG8_WAIT_V(4); PG8_BAR;
    PG8_STAGE(PG8_SB(1, 0), cB + kstep, voffB); PG8_STAGE(PG8_SA(1, 0), cA + kstep, voffA); PG8_STAGE(PG8_SB(1, 1), cB + hstep + kstep, voffB);
    PG8_WAIT_V(6); PG8_BAR;
    for (;;) {
        const bool has_next = S.next(ui + 1, nxt);
        const char* nA = has_next ? (const char*)g.A + (size_t)nxt.pm * tstep : cA; const char* nB = has_next ? (const char*)g.Bt + (size_t)nxt.pn * tstep : cB;
        for (int t = 0; t < nt; t += 2) {
            const bool last = (t == nt - 2);
            const char* a1 = cA + (size_t)(t + 1) * kstep;
            const char* a2 = last ? nA : cA + (size_t)(t + 2) * kstep; const char* b2 = last ? nB : cB + (size_t)(t + 2) * kstep;
            const char* a3 = a2 + kstep; const char* b3 = b2 + kstep;
            PG8_LDB(B0, 0, 0); PG8_SCHED; PG8_LDA(At, 0, 0); PG8_STAGE(PG8_SA(1, 1), a1 + hstep, voffA);
            PG8_WAIT_L(8); PG8_BAR; PG8_WAIT_L(0); PG8_MMA(0, 0, At, B0); PG8_BAR; PG8_SCHED;
            PG8_LDB(B1, 0, 1); PG8_STAGE(PG8_SB(0, 0), b2, voffB);
            PG8_BAR; PG8_WAIT_L(0); PG8_MMA(0, 1, At, B1); PG8_BAR;
            PG8_LDA(At, 0, 1); PG8_STAGE(PG8_SA(0, 0), a2, voffA);
            PG8_BAR; PG8_WAIT_L(0); PG8_MMA(1, 0, At, B0); PG8_BAR; PG8_SCHED;
            PG8_STAGE(PG8_SB(0, 1), b2 + hstep, voffB);
            PG8_WAIT_V(6); PG8_BAR; PG8_MMA(1, 1, At, B1); PG8_BAR;
            PG8_LDB(B0, 1, 0); PG8_SCHED; PG8_LDA(At, 1, 0); PG8_STAGE(PG8_SA(0, 1), a2 + hstep, voffA);
            PG8_WAIT_L(8); PG8_BAR; PG8_WAIT_L(0); PG8_MMA(0, 0, At, B0); PG8_BAR; PG8_SCHED;
            PG8_LDB(B1, 1, 1); PG8_STAGE(PG8_SB(1, 0), b3, voffB);
            PG8_BAR; PG8_WAIT_L(0); PG8_MMA(0, 1, At, B1); PG8_BAR;
            PG8_LDA(At, 1, 1); PG8_STAGE(PG8_SA(1, 0), a3, voffA);
            PG8_BAR; PG8_WAIT_L(0); PG8_MMA(1, 0, At, B0); PG8_BAR; PG8_SCHED;
            PG8_STAGE(PG8_SB(1, 1), b3 + hstep, voffB);
            PG8_WAIT_V(6); PG8_BAR; PG8_MMA(1, 1, At, B1); PG8_BAR;
        }
        E(acc, cur, wr, wc, fr, fq);
        if (!has_next) break;
#pragma unroll
        for (int a = 0; a < 2; ++a)
#pragma unroll
            for (int b = 0; b < 2; ++b)
#pragma unroll
                for (int m = 0; m < 4; ++m)
#pragma unroll
                    for (int n = 0; n < 2; ++n) acc[a][b][m][n] = (f32x4){0.f, 0.f, 0.f, 0.f};
        cur = nxt; cA = nA; cB = nB; ++ui;
    }
    PG8_WAIT_V(0);
    if (wr == 0) PG8_BAR;
    PG8_BAR;
#undef PG8_SA
#undef PG8_SB
#undef PG8_STAGE
#undef PG8_LDA
#undef PG8_LDB
#undef PG8_MMA
#undef PG8_WAIT_V
#undef PG8_WAIT_L
#undef PG8_BAR
#undef PG8_SCHED
}
}
using pg8::Unit;

struct EpiZ {
    static constexpr bool PERM = true;
    bf16_t* Z;
    __device__ __forceinline__ void operator()(const f32x4 (&acc)[2][2][4][2], const Unit& u, int wr, int wc, int fr, int fq) const {
        const int row0 = u.pm * 256 + wr * 64 + fr, col0 = u.pn * 256 + wc * 32 + 8 * fq;
#pragma unroll
        for (int ai = 0; ai < 2; ++ai)
#pragma unroll
            for (int m = 0; m < 4; ++m) { bf16_t* rowp = Z + (size_t)(row0 + ai * 128 + m * 16) * WIN + col0;
#pragma unroll
                for (int bj = 0; bj < 2; ++bj) { const f32x4 v0 = acc[ai][bj][m][0], v1 = acc[ai][bj][m][1];
                    u32x4 w; w.x = cvt_pk_bf16(v0[0], v0[1]); w.y = cvt_pk_bf16(v0[2], v0[3]); w.z = cvt_pk_bf16(v1[0], v1[1]); w.w = cvt_pk_bf16(v1[2], v1[3]);
                    *(u32x4*)(rowp + bj * 128) = w; } }
    }
};
struct EpiVT {
    static constexpr bool PERM = true;
    bf16_t* VT;
    __device__ __forceinline__ void operator()(const f32x4 (&acc)[2][2][4][2], const Unit& u, int wr, int wc, int fr, int fq) const {
        const int which = (u.pm >= 10) ? 1 : 0;
        const int row0 = which * 512 + (u.pm & 1) * 256 + wr * 64 + fr, col0 = u.pn * 256 + wc * 32 + 8 * fq;
#pragma unroll
        for (int ai = 0; ai < 2; ++ai)
#pragma unroll
            for (int m = 0; m < 4; ++m) { bf16_t* rowp = VT + (size_t)(row0 + ai * 128 + m * 16) * MG + col0;
#pragma unroll
                for (int bj = 0; bj < 2; ++bj) { const f32x4 v0 = acc[ai][bj][m][0], v1 = acc[ai][bj][m][1];
                    u32x4 w; w.x = cvt_pk_bf16(v0[0], v0[1]); w.y = cvt_pk_bf16(v0[2], v0[3]); w.z = cvt_pk_bf16(v1[0], v1[1]); w.w = cvt_pk_bf16(v1[2], v1[3]);
                    *(u32x4*)(rowp + bj * 128) = w; } }
    }
};
struct EpiSG {
    static constexpr bool PERM = true;
    bf16_t* SG;
    __device__ __forceinline__ void operator()(const f32x4 (&acc)[2][2][4][2], const Unit& u, int wr, int wc, int fr, int fq) const {
        const int row0 = u.pm * 256 + wr * 64 + fr, col0 = u.pn * 256 + wc * 32 + 8 * fq;
#pragma unroll
        for (int ai = 0; ai < 2; ++ai)
#pragma unroll
            for (int m = 0; m < 4; ++m) { bf16_t* rowp = SG + (size_t)(row0 + ai * 128 + m * 16) * 4096 + col0;
#pragma unroll
                for (int bj = 0; bj < 2; ++bj) { const f32x4 v0 = acc[ai][bj][m][0], v1 = acc[ai][bj][m][1];
                    u32x4 w; w.x = cvt_pk_bf16(sigm(v0[0]), sigm(v0[1])); w.y = cvt_pk_bf16(sigm(v0[2]), sigm(v0[3])); w.z = cvt_pk_bf16(sigm(v1[0]), sigm(v1[1])); w.w = cvt_pk_bf16(sigm(v1[2]), sigm(v1[3]));
                    *(u32x4*)(rowp + bj * 128) = w; } }
    }
};
struct EpiMerge {
    static constexpr bool PERM = true;
    const bf16_t* SG; float* PART; bf16_t* MERGED;
    __device__ __forceinline__ void operator()(const f32x4 (&acc)[2][2][4][2], const Unit& u, int wr, int wc, int fr, int fq) const {
        const int j = u.pn >> 2, pn = u.pn & 3, pm = u.pm & 63;
        const int row0 = pm * 256 + wr * 64 + fr, col0 = pn * 256 + wc * 32 + 8 * fq;
#pragma unroll
        for (int ai = 0; ai < 2; ++ai)
#pragma unroll
            for (int m = 0; m < 4; ++m) { const size_t row = (size_t)(row0 + ai * 128 + m * 16);
#pragma unroll
                for (int bj = 0; bj < 2; ++bj) { const int col = col0 + bj * 128;
                    const u32x4 sg = *(const u32x4*)(SG + row * 4096 + j * 1024 + col);
                    f32x4 v0 = acc[ai][bj][m][0], v1 = acc[ai][bj][m][1];
                    v0[0] *= bflo(sg.x); v0[1] *= bfhi(sg.x); v0[2] *= bflo(sg.y); v0[3] *= bfhi(sg.y);
                    v1[0] *= bflo(sg.z); v1[1] *= bfhi(sg.z); v1[2] *= bflo(sg.w); v1[3] *= bfhi(sg.w);
                    float* pp = PART + row * 1024 + col;
                    if (j > 0) { v0 += *(const f32x4*)pp; v1 += *(const f32x4*)(pp + 4); }
                    if (j < 3) { *(f32x4*)pp = v0; *(f32x4*)(pp + 4) = v1; }
                    else { u32x4 w; w.x = cvt_pk_bf16(v0[0], v0[1]); w.y = cvt_pk_bf16(v0[2], v0[3]); w.z = cvt_pk_bf16(v1[0], v1[1]); w.w = cvt_pk_bf16(v1[2], v1[3]);
                        *(u32x4*)(MERGED + row * 1024 + col) = w; } }
                asm volatile("" ::: "memory"); }
    }
};
struct EpiOut {
    static constexpr bool PERM = false;
    const float* xs0; const float* xs1; int split; float* out;
    __device__ __forceinline__ void operator()(const f32x4 (&acc)[2][2][4][2], const Unit& u, int wr, int wc, int fr, int fq) const {
        const int row0 = u.pm * 256 + wr * 64 + fr, col0 = u.pn * 256 + wc * 32 + 4 * fq;
        const float* xs = (u.pm * 256 < split) ? xs0 : xs1 - (size_t)split * 1024;
#pragma unroll
        for (int ai = 0; ai < 2; ++ai)
#pragma unroll
            for (int m = 0; m < 4; ++m) { const size_t off = (size_t)(row0 + ai * 128 + m * 16) * 1024 + col0;
#pragma unroll
                for (int bj = 0; bj < 2; ++bj)
#pragma unroll
                    for (int n = 0; n < 2; ++n) { const f32x4 b = *(const f32x4*)(xs + off + bj * 128 + n * 16);
                        *(f32x4*)(out + off + bj * 128 + n * 16) = b + acc[ai][bj][m][n]; }
                asm volatile("" ::: "memory"); }
    }
};
struct EpiPG {
    static constexpr bool PERM = false;
    float* PART;
    __device__ __forceinline__ void operator()(const f32x4 (&acc)[2][2][4][2], const Unit& u, int wr, int wc, int fr, int fq) const {
        const int row0 = u.pm * 256 + wr * 64 + fr, col0 = u.pn * 256 + wc * 32 + 4 * fq;
#pragma unroll
        for (int ai = 0; ai < 2; ++ai)
#pragma unroll
            for (int m = 0; m < 4; ++m) { const size_t off = (size_t)(row0 + ai * 128 + m * 16) * 1024 + col0;
#pragma unroll
                for (int bj = 0; bj < 2; ++bj)
#pragma unroll
                    for (int n = 0; n < 2; ++n) { const f32x4 v = acc[ai][bj][m][n];
                        *(f32x4*)(PART + off + bj * 128 + n * 16) = (f32x4){sigm(v[0]), sigm(v[1]), sigm(v[2]), sigm(v[3])}; } }
    }
};
struct EpiPle {
    static constexpr bool PERM = false;
    const float* PART; float* out;
    __device__ __forceinline__ void operator()(const f32x4 (&acc)[2][2][4][2], const Unit& u, int wr, int wc, int fr, int fq) const {
        const int row0 = u.pm * 256 + wr * 64 + fr, col0 = u.pn * 256 + wc * 32 + 4 * fq;
#pragma unroll
        for (int ai = 0; ai < 2; ++ai)
#pragma unroll
            for (int m = 0; m < 4; ++m) { const size_t off = (size_t)(row0 + ai * 128 + m * 16) * 1024 + col0;
#pragma unroll
                for (int bj = 0; bj < 2; ++bj)
#pragma unroll
                    for (int n = 0; n < 2; ++n) { const f32x4 gte = *(const f32x4*)(PART + off + bj * 128 + n * 16); const f32x4 x = *(const f32x4*)(out + off + bj * 128 + n * 16);
                        *(f32x4*)(out + off + bj * 128 + n * 16) = x + gte * acc[ai][bj][m][n]; }
                asm volatile("" ::: "memory"); }
    }
};

__device__ __forceinline__ void p0_item(const float* W, int K, int N, bf16_t* WT, int item, int lane, float* scr) {
    const int nblk = N / 32, kb = item / nblk, nb = item % nblk, k0 = 64 * kb, n0 = 32 * nb;
#pragma unroll 8
    for (int i = 0; i < 32; ++i) { const int kk = 2 * i + (lane >> 5); scr[kk * 33 + (lane & 31)] = W[(size_t)(k0 + kk) * N + n0 + (lane & 31)]; }
    LDS_WAIT();
    const int c = lane & 7;
#pragma unroll
    for (int j = 0; j < 4; ++j) { const int n = (lane >> 3) + 8 * j; const float* s = scr + (8 * c) * 33 + n;
        u32x4 o; o.x = cvt_pk_bf16(s[0 * 33], s[1 * 33]); o.y = cvt_pk_bf16(s[2 * 33], s[3 * 33]); o.z = cvt_pk_bf16(s[4 * 33], s[5 * 33]); o.w = cvt_pk_bf16(s[6 * 33], s[7 * 33]);
        *(u32x4*)(WT + (size_t)(n0 + n) * K + k0 + 8 * c) = o; }
    LDS_WAIT();
}
__device__ __forceinline__ void phase_p0(unsigned char* lds) {
    const int tid = fresh_tid(), lane = tid & 63, wave = tid >> 6;
    float* scr = (float*)(lds + wave * 8448);
    const int gw = blockIdx.x * 8 + wave, NGW = gridDim.x * 8;
    bf16_t* WTb = (bf16_t*)(AWS + WS_WT);
    constexpr int I_IN = 16 * 224, I_MG = 16 * 32, I_BR = 8 * 32, I_O = 512, I_PG = 512, I_PP = 4 * 32;
    constexpr int I_LAYER = I_IN + 4 * I_MG + 4 * I_BR + I_O + I_PG + I_PP;
    for (int it = gw; it < 2 * I_LAYER; it += NGW) {
        const int l = it / I_LAYER; int r = it % I_LAYER; bf16_t* wl = WTb + (size_t)l * WT_LAYER;
        if (r < I_IN) { p0_item(AIN(5) + (size_t)l * 1024 * WIN, 1024, WIN, wl + WT_IN, r, lane, scr); continue; } r -= I_IN;
        if (r < 4 * I_MG) { const int j = r / I_MG; p0_item(AIN(18) + (size_t)(l * 4 + j) * 1024 * 1024, 1024, 1024, wl + WT_MG + (size_t)j * 1024 * 1024, r % I_MG, lane, scr); continue; } r -= 4 * I_MG;
        if (r < 4 * I_BR) { const int j = r / I_BR; p0_item(AIN(17) + (size_t)(l * 4 + j) * 512 * 1024, 512, 1024, wl + WT_BR + (size_t)j * 1024 * 512, r % I_BR, lane, scr); continue; } r -= 4 * I_BR;
        if (r < I_O) { p0_item(AIN(19) + (size_t)l * 1024 * 1024, 1024, 1024, wl + WT_O, r, lane, scr); continue; } r -= I_O;
        if (r < I_PG) { p0_item(AIN(21) + (size_t)l * 1024 * 1024, 1024, 1024, wl + WT_PG, r, lane, scr); continue; } r -= I_PG;
        p0_item(AIN(22) + (size_t)l * 256 * 1024, 256, 1024, wl + WT_PP, r, lane, scr);
    }
    f32x2* rope = (f32x2*)(AWS + WS_ROPE);
    for (int e = blockIdx.x * NT + tid; e < T_ * 32; e += gridDim.x * NT) {
        const int t = e >> 5, i = e & 31;
        const float inv = exp2f(-(float)i * (13.287712379549449f / 32.0f));
        const float ang = (float)t * inv;
        rope[e] = (f32x2){cosf(ang), sinf(ang)};
    }
}

__device__ __forceinline__ const float* xrow_ptr(const unsigned char* lds, int l, int grow) {
    if (l == 0) return grow < NPROMPT ? AIN(0) + (size_t)grow * DM : AIN(1) + (size_t)(grow - NPROMPT) * DM;
    return AOUT + (size_t)grow * DM;
}
__device__ __forceinline__ void norm_rows_bf16(const unsigned char* lds, int g, int l, int gain_in, int gain_off, bool from_out) {
    const int tid = fresh_tid(), lane = tid & 63, wave = tid >> 6;
    const int gw = blockIdx.x * 8 + wave, NGW = gridDim.x * 8;
    bf16_t* H = (bf16_t*)(AWS + WS_H);
    f32x4 gv[4];
#pragma unroll
    for (int j = 0; j < 4; ++j) gv[j] = *((const f32x4*)(AIN(gain_in) + gain_off) + lane + 64 * j);
    for (int r = gw; r < MG; r += NGW) {
        const int grow = g * MG + r;
        const float* xr = from_out ? AOUT + (size_t)grow * DM : xrow_ptr(lds, l, grow);
        f32x4 v[4]; float s = 0.f;
#pragma unroll
        for (int j = 0; j < 4; ++j) { v[j] = *((const f32x4*)xr + lane + 64 * j); s += (v[j][0] * v[j][0] + v[j][1] * v[j][1]) + (v[j][2] * v[j][2] + v[j][3] * v[j][3]); }
        const float rstd = rsqrtf(wave_sum(s, lane) * (1.f / DM) + EPS_);
        u32x2* o8 = (u32x2*)(H + (size_t)r * DM) + lane;
#pragma unroll
        for (int j = 0; j < 4; ++j) { u32x2 w; w.x = cvt_pk_bf16(v[j][0] * rstd * gv[j][0], v[j][1] * rstd * gv[j][1]); w.y = cvt_pk_bf16(v[j][2] * rstd * gv[j][2], v[j][3] * rstd * gv[j][3]); o8[64 * j] = w; }
    }
}
__device__ __forceinline__ void p16_convert(const unsigned char* lds, int g, int l) {
    bf16_t* P16 = (bf16_t*)(AWS + WS_P16);
    const int n4 = MG * PLE / 4;
    const int tid = fresh_tid();
    for (int e = blockIdx.x * NT + tid; e < n4; e += gridDim.x * NT) {
        const int r = e >> 6, c4 = e & 63; const int grow = g * MG + r;
        const float* pr = grow < NPROMPT ? AIN(2) + ((size_t)l * NPROMPT + grow) * PLE : AIN(3) + ((size_t)l * 32768 + (grow - NPROMPT)) * PLE;
        const f32x4 v = *((const f32x4*)pr + c4);
        u32x2 w; w.x = cvt_pk_bf16(v[0], v[1]); w.y = cvt_pk_bf16(v[2], v[3]);
        *((u32x2*)(P16 + (size_t)r * PLE) + c4) = w;
    }
}
__device__ __forceinline__ void final_norm_rows(const unsigned char* lds, int g) {
    const int tid = fresh_tid(), lane = tid & 63, wave = tid >> 6;
    const int gw = blockIdx.x * 8 + wave, NGW = gridDim.x * 8;
    const float* gain = AIN(23);
    f32x4 gv[4];
#pragma unroll
    for (int j = 0; j < 4; ++j) gv[j] = *((const f32x4*)gain + lane + 64 * j);
    for (int r = gw; r < MG; r += NGW) {
        float* xr = AOUT + (size_t)(g * MG + r) * DM;
        f32x4 v[4]; float s = 0.f;
#pragma unroll
        for (int j = 0; j < 4; ++j) { v[j] = *((const f32x4*)xr + lane + 64 * j); s += (v[j][0] * v[j][0] + v[j][1] * v[j][1]) + (v[j][2] * v[j][2] + v[j][3] * v[j][3]); }
        const float rstd = rsqrtf(wave_sum(s, lane) * (1.f / DM) + EPS_);
#pragma unroll
        for (int j = 0; j < 4; ++j) *((f32x4*)xr + lane + 64 * j) = v[j] * rstd * gv[j];
    }
}

__device__ __forceinline__ bool arrive_last(unsigned* cnt, unsigned need, unsigned char* lds) {
    volatile LAS unsigned* flag = (volatile LAS unsigned*)((LAS unsigned char*)lds + LDS_CTL + 16);
    VM_WAIT();
    __syncthreads();
    if (fresh_tid() == 0) {
        __builtin_amdgcn_fence(__ATOMIC_RELEASE, "agent");
        VM_WAIT();
        const unsigned old = __hip_atomic_fetch_add(cnt, 1u, __ATOMIC_RELAXED, __HIP_MEMORY_SCOPE_AGENT);
        const bool last = (old + 1u == need);
        if (last) { __builtin_amdgcn_fence(__ATOMIC_ACQUIRE, "agent"); VM_WAIT(); }
        *flag = last ? 1u : 0u;
    }
    __syncthreads();
    const bool r = (*flag != 0u);
    __syncthreads();
    return r;
}

__device__ __forceinline__ void unit_D(unsigned char* lds, unsigned* ctl, int l, int u) {
    const int tid = fresh_tid(), lane = tid & 63, wave = tid >> 6;
    const int vs = u & 3, dir = (u >> 2) & 1, h = (u >> 3) & 3, s = u >> 5;
    float* qs = (float*)lds; float* fs = qs + 2048; float* vsm = fs + 2048; float* red = vsm + 512; float* lbs = red + 4096;
    const bf16_t* Z = (const bf16_t*)(AWS + WS_Z);
    bf16_t* OD = (bf16_t*)(AWS + WS_OD) + (size_t)dir * MG * 512;
    if (tid < 128) { float lb = 0.f;
        if (l > 0) { const float* lg = AIN(15); const float x0 = lg[(0 * 2 + dir) * 512 + h * 128 + tid], x1 = lg[(1 * 2 + dir) * 512 + h * 128 + tid]; lb = 1.f / (1.f + __expf(x0 - x1)); }
        lbs[tid] = lb; }
    __syncthreads();
    float S[4][2];
#pragma unroll
    for (int k = 0; k < 4; ++k) { S[k][0] = 0.f; S[k][1] = 0.f; }
    const int kg = tid >> 4, vg = tid & 15;
    const int si = tid >> 5, sk = (tid & 31) * 4;
    const int qcol = C_HQ + h * 128 + sk, fcol = (dir ? C_HFB : C_HFF) + h * 128 + sk, vcol = C_HI + h * 128 + vs * 32 + (tid & 31);
    const f32x4 lb4 = *(const f32x4*)(lbs + sk);
    for (int c = 0; c < 128; ++c) {
        { const int p = c * 16 + si; const int t = dir ? (T_ - 1 - p) : p;
          const bf16_t* zr = Z + (size_t)(s * T_ + t) * WIN;
          const u32x2 qq = *(const u32x2*)(zr + qcol); const u32x2 ff = *(const u32x2*)(zr + fcol); const bf16_t vv = zr[vcol];
          f32x4 qv, fv;
          qv[0] = siluf(bflo(qq.x)); qv[1] = siluf(bfhi(qq.x)); qv[2] = siluf(bflo(qq.y)); qv[3] = siluf(bfhi(qq.y));
          fv[0] = lb4[0] + (1.f - lb4[0]) * sigm(bflo(ff.x)); fv[1] = lb4[1] + (1.f - lb4[1]) * sigm(bfhi(ff.x));
          fv[2] = lb4[2] + (1.f - lb4[2]) * sigm(bflo(ff.y)); fv[3] = lb4[3] + (1.f - lb4[3]) * sigm(bfhi(ff.y));
          *(f32x4*)(qs + si * 128 + sk) = qv; *(f32x4*)(fs + si * 128 + sk) = fv; vsm[si * 32 + (tid & 31)] = bf2f(vv); }
        __syncthreads();
        float po[16][2];
#pragma unroll
        for (int i = 0; i < 16; ++i) {
            const f32x4 q4 = *(const f32x4*)(qs + i * 128 + kg * 4), f4 = *(const f32x4*)(fs + i * 128 + kg * 4); const f32x2 v2 = *(const f32x2*)(vsm + i * 32 + vg * 2);
            float o0 = 0.f, o1 = 0.f;
#pragma unroll
            for (int k = 0; k < 4; ++k) {
                S[k][0] = fmaf(f4[k], S[k][0] - v2[0], v2[0]); o0 = fmaf(S[k][0], q4[k], o0);
                S[k][1] = fmaf(f4[k], S[k][1] - v2[1], v2[1]); o1 = fmaf(S[k][1], q4[k], o1); }
            po[i][0] = o0; po[i][1] = o1;
        }
#pragma unroll
        for (int i = 0; i < 16; ++i) {
            float x0 = po[i][0], x1 = po[i][1];
            x0 += shx(x0, 16, lane); x0 += shx(x0, 32, lane); x1 += shx(x1, 16, lane); x1 += shx(x1, 32, lane);
            if ((lane >> 4) == 0) *(f32x2*)(red + (wave * 16 + i) * 32 + vg * 2) = (f32x2){x0, x1};
        }
        __syncthreads();
        { const int i = tid >> 5, vv = tid & 31; float sum = 0.f;
#pragma unroll
          for (int w = 0; w < 8; ++w) sum += red[(w * 16 + i) * 32 + vv];
          const int p = c * 16 + i; const int t = dir ? (T_ - 1 - p) : p;
          OD[(size_t)(s * T_ + t) * 512 + h * 128 + vs * 32 + vv] = f2bf(sum); }
    }
    if (arrive_last(ctl + 16 + s * 4 + h, 8u, lds)) {
        const bf16_t* OD0 = (const bf16_t*)(AWS + WS_OD); const bf16_t* OD1 = OD0 + (size_t)MG * 512;
        bf16_t* BR3 = (bf16_t*)(AWS + WS_BR) + (size_t)3 * MG * 512;
        const float* gain = AIN(16) + l * 512 + h * 128;
        const f32x2 gn = *(const f32x2*)(gain + lane * 2);
        for (int t = wave; t < T_; t += 8) {
            const size_t R = (size_t)(s * T_ + t);
            const unsigned w0 = *(const unsigned*)(OD0 + R * 512 + h * 128 + lane * 2), w1 = *(const unsigned*)(OD1 + R * 512 + h * 128 + lane * 2);
            const unsigned gz = *(const unsigned*)(Z + R * WIN + C_HG + h * 128 + lane * 2);
            const float o0 = bflo(w0) + bflo(w1), o1 = bfhi(w0) + bfhi(w1);
            const float rs = rsqrtf(wave_sum(o0 * o0 + o1 * o1, lane) * (1.f / 128.f) + EPS_);
            *(unsigned*)(BR3 + R * 512 + h * 128 + lane * 2) = cvt_pk_bf16(o0 * rs * gn[0] * siluf(bflo(gz)), o1 * rs * gn[1] * siluf(bfhi(gz)));
        }
    }
}

__device__ __forceinline__ void unit_C(unsigned char* lds, unsigned* ctl, int l, int u) {
    const int tid = fresh_tid(), lane = tid & 63, wave = tid >> 6, fr = lane & 15, fq = lane >> 4;
    const int dir = u & 1, n = (u >> 1) & 7, s = u >> 4;
    float* xin = (float*)lds;
    float* xc = xin + 67 * 64;
    float* gate = xc + 64 * 64;
    float* par = gate + 2 * 64 * 64;
    bf16_t* xcb = (bf16_t*)(par + 8 * 64);
    bf16_t* wT = xcb + 64 * 72;
    const bf16_t* Z = (const bf16_t*)(AWS + WS_Z);
    bf16_t* CS = (bf16_t*)(AWS + WS_CS) + (size_t)dir * MG * 512;
    {
        const float* wa = AIN(10) + (size_t)((l * 2 + dir) * 8 + n) * 4096; const float* wx = AIN(12) + (size_t)((l * 2 + dir) * 8 + n) * 4096;
        for (int e = tid; e < 4096; e += NT) { const int j = e >> 6, k = e & 63; wT[k * 72 + j] = f2bf(wa[e]); wT[(64 + k) * 72 + j] = f2bf(wx[e]); }
        if (tid < 256) par[tid] = AIN(8)[(size_t)(l * 4 + (tid >> 6)) * 512 + n * 64 + (tid & 63)];
        else if (tid < 320) par[tid] = AIN(9)[l * 512 + n * 64 + (tid & 63)];
        else if (tid < 384) par[tid] = AIN(11)[(l * 2 + dir) * 512 + n * 64 + (tid & 63)];
        else if (tid < 448) par[tid] = AIN(13)[(l * 2 + dir) * 512 + n * 64 + (tid & 63)];
        else { const float lam = AIN(14)[(l * 2 + dir) * 512 + n * 64 + (tid & 63)]; par[tid] = softplus_neg(lam); }
    }
    float hcar = 0.f;
    for (int ci = 0; ci < 32; ++ci) {
        const int t0 = dir ? (T_ - 64 * (ci + 1)) : 64 * ci;
        for (int e = tid; e < 67 * 64; e += NT) { const int r = e >> 6, c = e & 63; const int t = t0 - 2 + r;
            xin[e] = (t >= 0 && t < T_) ? bf2f(Z[(size_t)(s * T_ + t) * WIN + C_LX + n * 64 + c]) : 0.f; }
        __syncthreads();
        for (int e = tid; e < 4096; e += NT) { const int t = e >> 6, c = e & 63;
            float v = par[256 + c];
#pragma unroll
            for (int j = 0; j < 4; ++j) v = fmaf(par[j * 64 + c], xin[(t + j) * 64 + c], v);
            xc[e] = v; xcb[t * 72 + c] = f2bf(v); }
        __syncthreads();
        {
            const int mt = wave & 3, half = wave >> 2;
            bf16x8 af[2];
#pragma unroll
            for (int ks = 0; ks < 2; ++ks) af[ks] = *(const bf16x8*)(xcb + (mt * 16 + fr) * 72 + ks * 32 + fq * 8);
#pragma unroll
            for (int nt2 = 0; nt2 < 4; ++nt2) {
                f32x4 acc = (f32x4){0.f, 0.f, 0.f, 0.f};
#pragma unroll
                for (int ks = 0; ks < 2; ++ks) { const bf16x8 bfv = *(const bf16x8*)(wT + (half * 64 + nt2 * 16 + fr) * 72 + ks * 32 + fq * 8);
                    acc = __builtin_amdgcn_mfma_f32_16x16x32_bf16(af[ks], bfv, acc, 0, 0, 0); }
#pragma unroll
                for (int i = 0; i < 4; ++i) gate[half * 4096 + (mt * 16 + fq * 4 + i) * 64 + nt2 * 16 + fr] = acc[i];
            }
        }
        __syncthreads();
        for (int e = tid; e < 4096; e += NT) { const int c = e & 63;
            const float r = sigm(gate[e] + par[384 - 64 + c]), ii = sigm(gate[4096 + e] + par[448 - 64 + c]);
            const float la = -8.f * r * par[448 + c];
            const float av = __expf(la); const float bv = sqrtf(one_minus_exp(2.f * la)) * ii * xc[e];
            gate[e] = av; gate[4096 + e] = bv; }
        __syncthreads();
        if (wave == 0) {
#pragma unroll 8
            for (int i = 0; i < 64; ++i) { const int tt = dir ? 63 - i : i; hcar = fmaf(gate[tt * 64 + lane], hcar, gate[4096 + tt * 64 + lane]); xc[tt * 64 + lane] = hcar; }
        }
        __syncthreads();
        for (int e = tid; e < 4096; e += NT) { const int t = e >> 6, c = e & 63; CS[(size_t)(s * T_ + t0 + t) * 512 + n * 64 + c] = f2bf(xc[e]); }
        __syncthreads();
    }
    if (arrive_last(ctl + 48 + s * 8 + n, 2u, lds)) {
        const bf16_t* CS0 = (const bf16_t*)(AWS + WS_CS); const bf16_t* CS1 = CS0 + (size_t)MG * 512;
        bf16_t* BR2 = (bf16_t*)(AWS + WS_BR) + (size_t)2 * MG * 512;
        for (int e = tid; e < T_ * 32; e += NT) { const int t = e >> 5, c2 = (e & 31) * 2; const size_t R = (size_t)(s * T_ + t);
            const unsigned w0 = *(const unsigned*)(CS0 + R * 512 + n * 64 + c2), w1 = *(const unsigned*)(CS1 + R * 512 + n * 64 + c2);
            const unsigned gz = *(const unsigned*)(Z + R * WIN + C_LG + n * 64 + c2);
            *(unsigned*)(BR2 + R * 512 + n * 64 + c2) = cvt_pk_bf16((bflo(w0) + bflo(w1)) * siluf(bflo(gz)), (bfhi(w0) + bfhi(w1)) * siluf(bfhi(gz))); }
    }
}

__device__ __forceinline__ void unit_A(unsigned char* lds, int l, int u) {
    const int tid = fresh_tid(), lane = tid & 63, wave = tid >> 6, fr = lane & 15, fq = lane >> 4;
    const int qt = u & 7, h = (u >> 3) & 3, s = u >> 5, q0 = qt * 256;
    bf16_t* Ks = (bf16_t*)lds;
    bf16_t* Vs = Ks + 64 * 72;
    bf16_t* Ps = Vs + 128 * 72;
    const bf16_t* Z = (const bf16_t*)(AWS + WS_Z);
    const bf16_t* VT = (const bf16_t*)(AWS + WS_VT);
    const f32x2* rope = (const f32x2*)(AWS + WS_ROPE);
    const float LOG2E = 1.4426950408889634f;
    const float dlf = AIN(6)[(l * 2 + 0) * 4 + h], dlb = AIN(6)[(l * 2 + 1) * 4 + h];
    const float lgf2 = -softplus_neg(dlf) * LOG2E, lgb2 = -softplus_neg(dlb) * LOG2E;
    for (int e = tid; e < 256 * 32; e += NT) { const int r = e >> 5, i = e & 31; const int t = q0 + r;
        const bf16_t* zr = Z + (size_t)(s * T_ + t) * WIN + C_RQ + h * 64;
        const float x1 = bf2f(zr[i]), x2 = bf2f(zr[i + 32]); const f32x2 cs = rope[t * 32 + i];
        Ps[r * 72 + i] = f2bf(x1 * cs[0] - x2 * cs[1]); Ps[r * 72 + i + 32] = f2bf(x1 * cs[1] + x2 * cs[0]); }
    __syncthreads();
    bf16x8 qf[2][2];
#pragma unroll
    for (int m = 0; m < 2; ++m)
#pragma unroll
        for (int ks = 0; ks < 2; ++ks) qf[m][ks] = *(const bf16x8*)(Ps + (wave * 32 + m * 16 + fr) * 72 + ks * 32 + fq * 8);
    f32x4 O[2][8];
#pragma unroll
    for (int m = 0; m < 2; ++m)
#pragma unroll
        for (int nv = 0; nv < 8; ++nv) O[m][nv] = (f32x4){0.f, 0.f, 0.f, 0.f};
    __syncthreads();
    bf16_t* Pw = Ps + wave * 32 * 72;
    for (int kt = 0; kt < 32; ++kt) {
        const int s0 = kt * 64;
        for (int e = tid; e < 64 * 32; e += NT) { const int r = e >> 5, i = e & 31; const int t = s0 + r;
            const bf16_t* zr = Z + (size_t)(s * T_ + t) * WIN + C_RK + h * 64;
            const float x1 = bf2f(zr[i]), x2 = bf2f(zr[i + 32]); const f32x2 cs = rope[t * 32 + i];
            Ks[r * 72 + i] = f2bf((x1 * cs[0] - x2 * cs[1]) * 0.125f); Ks[r * 72 + i + 32] = f2bf((x1 * cs[1] + x2 * cs[0]) * 0.125f); }
        for (int e = tid; e < 128 * 8; e += NT) { const int dv = e >> 3, c8 = e & 7;
            *(u32x4*)(Vs + dv * 72 + c8 * 8) = *(const u32x4*)(VT + (size_t)(h * 128 + dv) * MG + s * T_ + s0 + c8 * 8); }
        __syncthreads();
        f32x4 Sx[2][4];
#pragma unroll
        for (int nn = 0; nn < 4; ++nn) {
            bf16x8 kf[2];
#pragma unroll
            for (int ks = 0; ks < 2; ++ks) kf[ks] = *(const bf16x8*)(Ks + (nn * 16 + fr) * 72 + ks * 32 + fq * 8);
#pragma unroll
            for (int m = 0; m < 2; ++m) { f32x4 c = (f32x4){0.f, 0.f, 0.f, 0.f};
                c = __builtin_amdgcn_mfma_f32_16x16x32_bf16(qf[m][0], kf[0], c, 0, 0, 0);
                c = __builtin_amdgcn_mfma_f32_16x16x32_bf16(qf[m][1], kf[1], c, 0, 0, 0); Sx[m][nn] = c; }
        }
#pragma unroll
        for (int m = 0; m < 2; ++m)
#pragma unroll
            for (int nn = 0; nn < 4; ++nn)
#pragma unroll
                for (int i = 0; i < 4; ++i) {
                    const int tq = q0 + wave * 32 + m * 16 + fq * 4 + i, sk = s0 + nn * 16 + fr; const int d = tq - sk;
                    const float w = d > 0 ? __builtin_amdgcn_exp2f(lgf2 * (float)d) : (d < 0 ? __builtin_amdgcn_exp2f(lgb2 * (float)(-d)) : 2.0f);
                    Pw[(m * 16 + fq * 4 + i) * 72 + nn * 16 + fr] = f2bf(Sx[m][nn][i] * w);
                }
        __syncthreads();
        bf16x8 pf[2][2];
#pragma unroll
        for (int m = 0; m < 2; ++m)
#pragma unroll
            for (int ks = 0; ks < 2; ++ks) pf[m][ks] = *(const bf16x8*)(Pw + (m * 16 + fr) * 72 + ks * 32 + fq * 8);
#pragma unroll
        for (int nv = 0; nv < 8; ++nv) {
            bf16x8 vf[2];
#pragma unroll
            for (int ks = 0; ks < 2; ++ks) vf[ks] = *(const bf16x8*)(Vs + (nv * 16 + fr) * 72 + ks * 32 + fq * 8);
#pragma unroll
            for (int m = 0; m < 2; ++m) { O[m][nv] = __builtin_amdgcn_mfma_f32_16x16x32_bf16(pf[m][0], vf[0], O[m][nv], 0, 0, 0);
                O[m][nv] = __builtin_amdgcn_mfma_f32_16x16x32_bf16(pf[m][1], vf[1], O[m][nv], 0, 0, 0); }
        }
        __syncthreads();
    }
    bf16_t* BR0 = (bf16_t*)(AWS + WS_BR);
#pragma unroll
    for (int m = 0; m < 2; ++m)
#pragma unroll
        for (int i = 0; i < 4; ++i) {
            float ss = 0.f;
#pragma unroll
            for (int nv = 0; nv < 8; ++nv) ss += O[m][nv][i] * O[m][nv][i];
            ss += shx(ss, 1, lane); ss += shx(ss, 2, lane); ss += shx(ss, 4, lane); ss += shx(ss, 8, lane);
            const float rs = rsqrtf(ss * (1.f / 128.f) + EPS_);
            const size_t R = (size_t)(s * T_ + q0 + wave * 32 + m * 16 + fq * 4 + i);
#pragma unroll
            for (int nv = 0; nv < 8; ++nv) { const int dv = nv * 16 + fr;
                const float gz = bf2f(Z[R * WIN + C_RG + h * 128 + dv]);
                BR0[R * 512 + h * 128 + dv] = f2bf(O[m][nv][i] * rs * siluf(gz)); }
        }
}

__device__ __forceinline__ void unit_B(unsigned char* lds, int l, int u) {
    const int tid = fresh_tid(), lane = tid & 63, wave = tid >> 6, fr = lane & 15, fq = lane >> 4;
    const int rp = u & 15, h = (u >> 4) & 7, s = u >> 7;
    float* rpbs = (float*)lds;
    bf16_t* Ps = (bf16_t*)(lds + 2048) + wave * 16 * 264;
    const bf16_t* Z = (const bf16_t*)(AWS + WS_Z);
    const bf16_t* VT = (const bf16_t*)(AWS + WS_VT) + (size_t)512 * MG;
    if (tid < 465) rpbs[tid] = AIN(7)[(size_t)(l * 8 + h) * 465 + tid];
    __syncthreads();
    const int row = rp * 2 + (wave >> 2), jb = wave & 3;
    const int rs = min(max(row - 4, 0), 24), kstart = min(max(16 * jb - 8, 0), 32);
    const size_t Rb = (size_t)s * T_;
    bf16x8 qf[2];
#pragma unroll
    for (int ks = 0; ks < 2; ++ks) qf[ks] = *(const bf16x8*)(Z + (Rb + row * 64 + 16 * jb + fr) * WIN + C_NQ + h * 64 + ks * 32 + fq * 8);
    f32x4 Sx[16];
#pragma unroll
    for (int nt2 = 0; nt2 < 16; ++nt2) {
        const int tok = (rs + (nt2 >> 1)) * 64 + kstart + (nt2 & 1) * 16 + fr;
        const bf16_t* kr = Z + (Rb + tok) * WIN + C_NK + h * 64 + fq * 8;
        const bf16x8 k0 = *(const bf16x8*)kr, k1 = *(const bf16x8*)(kr + 32);
        f32x4 c = (f32x4){0.f, 0.f, 0.f, 0.f};
        c = __builtin_amdgcn_mfma_f32_16x16x32_bf16(qf[0], k0, c, 0, 0, 0);
        c = __builtin_amdgcn_mfma_f32_16x16x32_bf16(qf[1], k1, c, 0, 0, 0);
        Sx[nt2] = c;
    }
    float mx[4], sm[4];
#pragma unroll
    for (int i = 0; i < 4; ++i) mx[i] = -1e30f;
#pragma unroll
    for (int nt2 = 0; nt2 < 16; ++nt2) {
        const int kcol = kstart + (nt2 & 1) * 16 + fr; const int dr = rs + (nt2 >> 1) - row + 7;
#pragma unroll
        for (int i = 0; i < 4; ++i) {
            const int qcol = 16 * jb + fq * 4 + i; const int wst = min(max(qcol - 8, 0), 48);
            const bool ok = (kcol >= wst) && (kcol < wst + 16);
            const int dc = min(max(kcol - qcol + 15, 0), 30);
            const float v = ok ? Sx[nt2][i] * 0.125f + rpbs[dr * 31 + dc] : -1e30f;
            Sx[nt2][i] = v; mx[i] = fmaxf(mx[i], v);
        }
    }
#pragma unroll
    for (int i = 0; i < 4; ++i) { float m = mx[i]; m = fmaxf(m, shx(m, 1, lane)); m = fmaxf(m, shx(m, 2, lane)); m = fmaxf(m, shx(m, 4, lane)); m = fmaxf(m, shx(m, 8, lane)); mx[i] = m; sm[i] = 0.f; }
#pragma unroll
    for (int nt2 = 0; nt2 < 16; ++nt2)
#pragma unroll
        for (int i = 0; i < 4; ++i) { const float v = Sx[nt2][i]; const float p = v > -1e29f ? __expf(v - mx[i]) : 0.f; sm[i] += p;
            Ps[(fq * 4 + i) * 264 + nt2 * 16 + fr] = f2bf(p); }
#pragma unroll
    for (int i = 0; i < 4; ++i) { float x = sm[i]; x += shx(x, 1, lane); x += shx(x, 2, lane); x += shx(x, 4, lane); x += shx(x, 8, lane); sm[i] = 1.f / x; }
    __syncthreads();
    f32x4 O[4];
#pragma unroll
    for (int nd = 0; nd < 4; ++nd) O[nd] = (f32x4){0.f, 0.f, 0.f, 0.f};
#pragma unroll
    for (int ks = 0; ks < 8; ++ks) {
        const bf16x8 pf = *(const bf16x8*)(Ps + fr * 264 + ks * 32 + fq * 8);
        const size_t tokb = Rb + (rs + ks) * 64 + kstart + fq * 8;
#pragma unroll
        for (int nd = 0; nd < 4; ++nd) { const bf16x8 vf = *(const bf16x8*)(VT + (size_t)(h * 64 + nd * 16 + fr) * MG + tokb);
            O[nd] = __builtin_amdgcn_mfma_f32_16x16x32_bf16(pf, vf, O[nd], 0, 0, 0); }
    }
    bf16_t* BR1 = (bf16_t*)(AWS + WS_BR) + (size_t)MG * 512;
#pragma unroll
    for (int i = 0; i < 4; ++i) { const size_t R = Rb + row * 64 + 16 * jb + fq * 4 + i;
#pragma unroll
        for (int nd = 0; nd < 4; ++nd) { const int d = nd * 16 + fr;
            const float gz = bf2f(Z[R * WIN + C_NG + h * 64 + d]);
            BR1[R * 512 + h * 64 + d] = f2bf(O[nd][i] * sm[i] * siluf(gz)); } }
    __syncthreads();
}

__global__ void __launch_bounds__(NT, 2) mega(Args a) {
    extern __shared__ __attribute__((aligned(16))) unsigned char lds[];
    cg::grid_group grid = cg::this_grid();
    LAS unsigned char* ldsl = (LAS unsigned char*)lds;
    {
        const int t0 = threadIdx.x;
        if (t0 < 24) *(unsigned long long*)(lds + LDS_TAB + 8 * t0) = (unsigned long long)a.in[t0];
        if (t0 == 24) *(unsigned long long*)(lds + LDS_TAB + 8 * 24) = (unsigned long long)a.out;
        if (t0 == 25) *(unsigned long long*)(lds + LDS_TAB + 8 * 25) = (unsigned long long)a.ws;
        __syncthreads();
    }

    phase_p0(lds);
    norm_rows_bf16(lds, 0, 0, 4, 0, false);
    p16_convert(lds, 0, 0);
    grid.sync();

    for (int g = 0; g < NGRP; ++g) {
        for (int l = 0; l < DEPTH_; ++l) {
            if (l > 0) { norm_rows_bf16(lds, g, l, 4, l * DM, true); p16_convert(lds, g, l); grid.sync(); }
            {
                unsigned char* ws = AWS; const bf16_t* wl = (const bf16_t*)(ws + WS_WT) + (size_t)l * WT_LAYER; const bf16_t* H = (const bf16_t*)(ws + WS_H);
                { pg8::Gemm gm{H, wl + WT_IN, MG, WIN, DM}; pg8::ZOrder S; S.init(gridDim.x, blockIdx.x); EpiZ E{(bf16_t*)(ws + WS_Z)};
                  pg8::gemm_phase<EpiZ, pg8::ZOrder>(ldsl, gm, S, E); }
                { pg8::Gemm gm{wl + WT_IN, H, WIN, MG, DM}; pg8::VTOrder S{(int)gridDim.x, (int)blockIdx.x}; EpiVT E{(bf16_t*)(ws + WS_VT)};
                  pg8::gemm_phase<EpiVT, pg8::VTOrder>(ldsl, gm, S, E); }
            }
            grid.sync();
            {
                unsigned* ctl = (unsigned*)(AWS + WS_CTL) + (g * 2 + l) * CTL_SLOT;
                volatile LAS unsigned* qw = (volatile LAS unsigned*)((LAS unsigned char*)lds + LDS_CTL);
                for (;;) {
                    __syncthreads();
                    if (fresh_tid() == 0) *qw = __hip_atomic_fetch_add(ctl, 1u, __ATOMIC_RELAXED, __HIP_MEMORY_SCOPE_AGENT);
                    __syncthreads();
                    const int u = (int)*qw;
                    if (u >= NU_ALL) break;
                    if (u < NU_D) unit_D(lds, ctl, l, u);
                    else if (u < NU_D + NU_A) unit_A(lds, l, u - NU_D);
                    else if (u < NU_D + NU_A + NU_C) unit_C(lds, ctl, l, u - NU_D - NU_A);
                    else unit_B(lds, l, u - NU_D - NU_A - NU_C);
                }
            }
            grid.sync();
            {
                unsigned char* ws = AWS; const bf16_t* wl = (const bf16_t*)(ws + WS_WT) + (size_t)l * WT_LAYER;
                { pg8::Gemm gm{(const bf16_t*)(ws + WS_H), wl + WT_MG, MG, 4096, DM}; pg8::TileOrder S{(int)gridDim.x, (int)blockIdx.x, 4, 0}; EpiSG E{(bf16_t*)(ws + WS_SG)};
                  pg8::gemm_phase<EpiSG, pg8::TileOrder>(ldsl, gm, S, E); }
                { pg8::Gemm gm{(const bf16_t*)(ws + WS_BR), wl + WT_BR, 4 * MG, 4096, 512}; pg8::TileOrder S{(int)gridDim.x, (int)blockIdx.x, 4, 64};
                  EpiMerge E{(const bf16_t*)(ws + WS_SG), (float*)(ws + WS_PART), (bf16_t*)(ws + WS_MERGED)};
                  pg8::gemm_phase<EpiMerge, pg8::TileOrder>(ldsl, gm, S, E); }
            }
            grid.sync();
            {
                unsigned char* ws = AWS; const bf16_t* wl = (const bf16_t*)(ws + WS_WT) + (size_t)l * WT_LAYER; float* outg = AOUT + (size_t)g * MG * DM;
                pg8::Gemm gm{(const bf16_t*)(ws + WS_MERGED), wl + WT_O, MG, DM, DM}; pg8::StaticOrder S; S.init(MG, DM, gridDim.x, blockIdx.x);
                EpiOut E;
                if (l == 0) { const int grow0 = g * MG; if (grow0 < NPROMPT) { E.xs0 = AIN(0) + (size_t)grow0 * DM; E.xs1 = AIN(1); E.split = NPROMPT - grow0; }
                                                        else { E.xs0 = AIN(1) + (size_t)(grow0 - NPROMPT) * DM; E.xs1 = E.xs0; E.split = MG; } }
                else { E.xs0 = outg; E.xs1 = outg; E.split = MG; }
                E.out = outg;
                pg8::gemm_phase<EpiOut, pg8::StaticOrder>(ldsl, gm, S, E);
            }
            grid.sync();
            norm_rows_bf16(lds, g, l, 20, l * DM, true);
            grid.sync();
            {
                unsigned char* ws = AWS; const bf16_t* wl = (const bf16_t*)(ws + WS_WT) + (size_t)l * WT_LAYER; float* outg = AOUT + (size_t)g * MG * DM;
                { pg8::Gemm gm{(const bf16_t*)(ws + WS_H), wl + WT_PG, MG, DM, DM}; pg8::TileOrder S{(int)gridDim.x, (int)blockIdx.x, 1, 0}; EpiPG E{(float*)(ws + WS_PART)};
                  pg8::gemm_phase<EpiPG, pg8::TileOrder>(ldsl, gm, S, E); }
                { pg8::Gemm gm{(const bf16_t*)(ws + WS_P16), wl + WT_PP, MG, DM, PLE}; pg8::TileOrder S{(int)gridDim.x, (int)blockIdx.x, 1, 0}; EpiPle E{(const float*)(ws + WS_PART), outg};
                  pg8::gemm_phase<EpiPle, pg8::TileOrder>(ldsl, gm, S, E); }
            }
            grid.sync();
        }
        final_norm_rows(lds, g);
        if (g + 1 < NGRP) { norm_rows_bf16(lds, g + 1, 0, 4, 0, false); p16_convert(lds, g + 1, 0); grid.sync(); }
    }
}

extern "C" void kernel_launch(void* const* d_in, const int* in_sizes, int n_in, void* d_out, int out_size, void* d_ws, size_t ws_size, hipStream_t stream) {
    static int grid = 0;
    if (grid == 0) {
        if (n_in != 24 || ws_size < WS_END || out_size != 3 * MG * DM) { fprintf(stderr, "kernel_launch: unexpected shapes (n_in %d, ws %zu, out %d)\n", n_in, ws_size, out_size); grid = -1; return; }
        int dev = 0, cus = 0, per_cu = 0;
        (void)hipGetDevice(&dev);
        (void)hipDeviceGetAttribute(&cus, hipDeviceAttributeMultiprocessorCount, dev);
        (void)hipFuncSetAttribute((const void*)mega, hipFuncAttributeMaxDynamicSharedMemorySize, LDS_BYTES);
        (void)hipOccupancyMaxActiveBlocksPerMultiprocessor(&per_cu, (const void*)mega, NT, LDS_BYTES);
        (void)hipGetLastError();
        if (per_cu < 1) { fprintf(stderr, "kernel_launch: occupancy query says %d blocks per CU\n", per_cu); per_cu = 1; }
        grid = cus > 0 ? cus : 256;
    }
    if (grid < 0) return;
    (void)hipMemsetAsync((char*)d_ws + WS_CTL, 0, 65536, stream);
    Args a{};
    for (int i = 0; i < 24; ++i) a.in[i] = (const float*)d_in[i];
    a.out = (float*)d_out; a.ws = (unsigned char*)d_ws;
    void* args[] = {&a};
    hipError_t e = hipLaunchCooperativeKernel((const void*)mega, dim3(grid), dim3(NT), args, LDS_BYTES, stream);
    if (e != hipSuccess) fprintf(stderr, "cooperative launch failed: %s (grid %d)\n", hipGetErrorString(e), grid);
}
```
